# Optimizing an MI355X kernel written in HIP

```python
import math
import jax, jax.numpy as jnp
from jax import lax
import numpy as np

D_MODEL = 1024
BATCH = 2
SEQ = 8192
DEPTH = 1

GRID_W = 64
HEAD_DIM_A = 128
N_Q_HEADS_A = 8
N_KV_HEADS_A = 2
ROPE_THETA = 10000.0
Q_BLOCK = 128
HEAD_DIM_B = 64
N_HEADS_PER_DIL = 4
DIL_PAIRS = ((128, 1), (512, 4), (2048, 16))
N_HEADS_B = N_HEADS_PER_DIL * len(DIL_PAIRS)
BAND_BLOCK = 64
N_REL_BUCKETS = 32
REL_MAX_DIST = 1024
D_FF = 4 * D_MODEL
D_PLE = 256
NORM_EPS = 1e-6
NEG_INF = -1e30

SPLIT_SIZES = (
    N_Q_HEADS_A * HEAD_DIM_A,
    N_KV_HEADS_A * HEAD_DIM_A,
    N_KV_HEADS_A * HEAD_DIM_A,
    N_HEADS_B * HEAD_DIM_B,
    N_HEADS_B * HEAD_DIM_B,
    N_HEADS_B * HEAD_DIM_B,
    D_MODEL,
    D_MODEL,
)
D_IN_PROJ = sum(SPLIT_SIZES)

kernel_name = "hybrid_gqa_axialrope_dilated_swa_sqrelu_ple"


def rmsnorm(x, g):
    xf = x.astype(jnp.float32)
    y = xf * lax.rsqrt(jnp.mean(xf * xf, axis=-1, keepdims=True) + NORM_EPS)
    return (y * g.astype(jnp.float32)).astype(x.dtype)


def rope_1d(x, pos):
    d = x.shape[-1]
    inv_freq = jnp.power(ROPE_THETA, -jnp.arange(0, d, 2, dtype=jnp.float32) / d)
    ang = pos.astype(jnp.float32)[:, None] * inv_freq[None, :]
    cos = jnp.cos(ang)[None, :, None, :]
    sin = jnp.sin(ang)[None, :, None, :]
    xf = x.astype(jnp.float32)
    x1, x2 = xf[..., : d // 2], xf[..., d // 2:]
    out = jnp.concatenate([x1 * cos - x2 * sin, x2 * cos + x1 * sin], axis=-1)
    return out.astype(x.dtype)


def axial_rope(x, row_ids, col_ids):
    half = x.shape[-1] // 2
    return jnp.concatenate([rope_1d(x[..., :half], row_ids),
                            rope_1d(x[..., half:], col_ids)], axis=-1)


def t5_bucket(rel):
    nb = N_REL_BUCKETS // 2
    ret = (rel > 0).astype(np.int32) * nb
    n = np.abs(rel)
    max_exact = nb // 2
    large = max_exact + (np.log(np.maximum(n, 1) / max_exact)
                         / math.log(REL_MAX_DIST / max_exact)
                         * (nb - max_exact)).astype(np.int32)
    large = np.minimum(large, nb - 1)
    return ret + np.where(n < max_exact, n, large).astype(np.int32)


def mixer_a(q, k, v, q_g, k_g, row_ids, col_ids):
    b, s, hq, hd = q.shape
    hkv = k.shape[2]
    grp = hq // hkv
    q = axial_rope(rmsnorm(q, q_g), row_ids, col_ids) * (hd ** -0.5)
    k = axial_rope(rmsnorm(k, k_g), row_ids, col_ids)
    nblk = s // Q_BLOCK
    qb = q.reshape(b, nblk, Q_BLOCK, hkv, grp, hd).transpose(1, 0, 3, 4, 2, 5)
    kt = k.transpose(0, 2, 1, 3)
    vt = v.transpose(0, 2, 1, 3)

    def attend(qblk):
        sc = jnp.einsum('bkgqd,bksd->bkgqs', qblk, kt).astype(jnp.float32)
        pr = jax.nn.softmax(sc, axis=-1).astype(vt.dtype)
        return jnp.einsum('bkgqs,bksd->bkgqd', pr, vt)

    o = lax.map(attend, qb)
    return o.transpose(1, 0, 4, 2, 3, 5).reshape(b, s, hq * hd)


def dilated_group(q, k, v, bias_table, window, dilation):
    b, s, hh, hd = q.shape
    L = s // dilation
    W = window // (2 * dilation)
    qb_len = math.gcd(L, BAND_BLOCK)
    nb = L // qb_len
    kw_len = qb_len + 2 * W

    def to_sub(t):
        return t.reshape(b, L, dilation, hh, hd).transpose(0, 2, 3, 1, 4)

    off = np.arange(kw_len)[None, :] - W - np.arange(qb_len)[:, None]
    band = np.abs(off) <= W
    kpos = np.arange(nb)[:, None] * qb_len - W + np.arange(kw_len)[None, :]
    inb = (kpos >= 0) & (kpos < L)
    mask = band[None, :, :] & inb[:, None, :]
    bucket = t5_bucket(off * dilation)
    bias = bias_table[bucket].astype(jnp.float32).transpose(2, 0, 1)
    idx = np.arange(nb)[:, None] * qb_len + np.arange(kw_len)[None, :]

    qs = to_sub(q).reshape(b, dilation, hh, nb, qb_len, hd) * (hd ** -0.5)
    pad = ((0, 0), (0, 0), (0, 0), (W, W), (0, 0))
    ks = jnp.pad(to_sub(k), pad)[:, :, :, idx, :]
    vs = jnp.pad(to_sub(v), pad)[:, :, :, idx, :]
    sc = jnp.einsum('bchnqd,bchnkd->bchnqk', qs, ks).astype(jnp.float32) + bias[:, None]
    sc = jnp.where(mask, sc, NEG_INF)
    lse = jax.nn.logsumexp(sc, axis=-1)
    pr = jnp.exp(sc - lse[..., None]).astype(vs.dtype)
    o = jnp.einsum('bchnqk,bchnkd->bchnqd', pr, vs)
    o = o.reshape(b, dilation, hh, L, hd).transpose(0, 3, 1, 2, 4).reshape(b, s, hh, hd)
    lse = lse.reshape(b, dilation, hh, L).transpose(0, 3, 1, 2).reshape(b, s, hh)
    return o, lse


def mixer_b(q, k, v, rel_bias):
    b, s, _, hd = q.shape
    outs, lses = [], []
    for g, (window, dilation) in enumerate(DIL_PAIRS):
        sl = slice(g * N_HEADS_PER_DIL, (g + 1) * N_HEADS_PER_DIL)
        o, l = dilated_group(q[:, :, sl], k[:, :, sl], v[:, :, sl], rel_bias[:, sl], window, dilation)
        outs.append(o)
        lses.append(l)
    wts = jax.nn.softmax(jnp.stack(lses, axis=0), axis=0).astype(q.dtype)
    o = jnp.sum(wts[..., None] * jnp.stack(outs, axis=0), axis=0)
    return o.reshape(b, s, N_HEADS_PER_DIL * hd)


def setup_inputs(seed: int = 0) -> dict:
    key = jax.random.key(seed)
    ks = jax.random.split(key, 20)
    f32 = jnp.float32

    def w(k, shape, fan_in):
        return jax.random.normal(k, shape, f32) * (fan_in ** -0.5)

    def gain(k, shape):
        return 1.0 + 0.05 * jax.random.normal(k, shape, f32)

    return {
        "x": jax.random.normal(ks[0], (BATCH, SEQ, D_MODEL), f32),
        "p": jax.random.normal(ks[1], (DEPTH, BATCH, SEQ, D_PLE), f32),
        "norm_mix_g": gain(ks[2], (DEPTH, D_MODEL)),
        "w_in": w(ks[3], (DEPTH, D_MODEL, D_IN_PROJ), D_MODEL),
        "b_gate": 0.02 * jax.random.normal(ks[4], (DEPTH, 2 * D_MODEL), f32),
        "q_norm_g": gain(ks[5], (DEPTH, HEAD_DIM_A)),
        "k_norm_g": gain(ks[6], (DEPTH, HEAD_DIM_A)),
        "rel_bias": 0.5 * jax.random.normal(ks[7], (N_REL_BUCKETS, N_HEADS_B), f32),
        "w_out_a": w(ks[8], (DEPTH, N_Q_HEADS_A * HEAD_DIM_A, D_MODEL), N_Q_HEADS_A * HEAD_DIM_A),
        "w_out_b": w(ks[9], (DEPTH, N_HEADS_PER_DIL * HEAD_DIM_B, D_MODEL), N_HEADS_PER_DIL * HEAD_DIM_B),
        "w_out": w(ks[10], (DEPTH, D_MODEL, D_MODEL), D_MODEL),
        "norm_mlp_g": gain(ks[11], (DEPTH, D_MODEL)),
        "w_ff1": w(ks[12], (DEPTH, D_MODEL, D_FF), D_MODEL),
        "w_ff2": w(ks[13], (DEPTH, D_FF, D_MODEL), D_FF),
        "norm_ple_g": gain(ks[14], (DEPTH, D_MODEL)),
        "w_ple_gate": w(ks[15], (DEPTH, D_MODEL, D_MODEL), D_MODEL),
        "w_ple": w(ks[16], (DEPTH, D_PLE, D_MODEL), D_PLE),
        "final_norm_g": gain(ks[17], (D_MODEL,)),
    }


def reference(x, p, norm_mix_g, w_in, b_gate, q_norm_g, k_norm_g, rel_bias,
              w_out_a, w_out_b, w_out, norm_mlp_g, w_ff1, w_ff2,
              norm_ple_g, w_ple_gate, w_ple, final_norm_g):
    b, s, _ = x.shape
    rows = s // GRID_W
    row_ids = jnp.repeat(jnp.arange(rows, dtype=jnp.int32), GRID_W)
    col_ids = jnp.arange(s, dtype=jnp.int32) % GRID_W
    split_at = list(np.cumsum(SPLIT_SIZES)[:-1])

    for i in range(DEPTH):
        h = rmsnorm(x, norm_mix_g[i])
        z = h @ w_in[i]
        qa, ka, va, qb, kb, vb, ga, gb = jnp.split(z, split_at, axis=-1)
        qa = qa.reshape(b, s, N_Q_HEADS_A, HEAD_DIM_A)
        ka = ka.reshape(b, s, N_KV_HEADS_A, HEAD_DIM_A)
        va = va.reshape(b, s, N_KV_HEADS_A, HEAD_DIM_A)
        qb = qb.reshape(b, s, N_HEADS_B, HEAD_DIM_B)
        kb = kb.reshape(b, s, N_HEADS_B, HEAD_DIM_B)
        vb = vb.reshape(b, s, N_HEADS_B, HEAD_DIM_B)

        y_a = mixer_a(qa, ka, va, q_norm_g[i], k_norm_g[i], row_ids, col_ids) @ w_out_a[i]
        y_b = mixer_b(qb, kb, vb, rel_bias) @ w_out_b[i]
        gate_a = jax.nn.sigmoid(ga + b_gate[i, :D_MODEL])
        gate_b = jax.nn.sigmoid(gb + b_gate[i, D_MODEL:])
        x = x + (gate_a * y_a + gate_b * y_b) @ w_out[i]

        h = rmsnorm(x, norm_mlp_g[i])
        x = x + jnp.square(jax.nn.relu(h @ w_ff1[i])) @ w_ff2[i]

        gate_p = jax.nn.sigmoid(rmsnorm(x, norm_ple_g[i]) @ w_ple_gate[i])
        x = x + gate_p * (p[i] @ w_ple[i])

    return rmsnorm(x, final_norm_g)
```

```cpp
#include <hip/hip_runtime.h>
#include <hip/hip_bf16.h>
#include <cstdio>
#include <cstdint>
#include <cmath>
namespace pg8 {
#define PG8_LAS __attribute__((address_space(3)))
typedef unsigned short bf16_t;
typedef short bf16x8 __attribute__((ext_vector_type(8)));
typedef float f32x4 __attribute__((ext_vector_type(4)));
typedef unsigned u32x4 __attribute__((ext_vector_type(4)));
constexpr int BM = 256, BK = 64, HALF = 128, HTB = HALF * BK * 2  , STAGE_BYTES = 8 * HTB, NXCD = 8, WGM = 8;

__host__ __device__ __forceinline__ int lds_byte(int r, int c) { const int st = (r >> 4) * 2 + (c >> 5), rr = r & 15, cc = c & 31, ob = rr * 64 + cc * 2; return st * 1024 + (ob ^ (((ob >> 9) & 1) << 5)); }
__host__ __device__ __forceinline__ void stage_rc(int b, int& R, int& C) { const int st = b / 1024, sb = b % 1024, swz = sb ^ (((sb >> 9) & 1) << 5); R = (st >> 1) * 16 + swz / 64; C = (st & 1) * 32 + (swz % 64) / 2; }
__host__ __device__ __forceinline__ int perm32(int rho) { const int n = rho >> 4, i = rho & 15; return 8 * (i >> 2) + 4 * n + (i & 3); }

struct Unit { int pm, pn; };
struct Gemm { const bf16_t* A; const bf16_t* Bt; int M, N, K; };

struct StaticOrder {
    int nM, nN, nwg, G, c;
    __host__ __device__ void init(int M, int N, int G_, int c_) { nM = M / BM; nN = N / BM; nwg = nM * nN; G = G_; c = c_; }
    __host__ __device__ bool next(int i, Unit& u) const {
        const long L = (long)i * G + c; if (L >= nwg) return false;
        int wgid = (int)L; { const int q = nwg / NXCD, r = nwg % NXCD, xcd = wgid % NXCD, off = wgid / NXCD; wgid = (xcd < r ? xcd * (q + 1) : r * (q + 1) + (xcd - r) * q) + off; }
        const int nig = WGM * nN, gid = wgid / nig, fm = gid * WGM, gsz = (nM - fm) < WGM ? (nM - fm) : WGM;
        u.pm = fm + ((wgid % nig) % gsz); u.pn = (wgid % nig) / gsz; return true;
    }
    __device__ __forceinline__ void a_ready(const Unit&) const {}
    __device__ __forceinline__ void done(const Unit&) const {}
};

__device__ __forceinline__ unsigned cvt_pk_bf16(float lo, float hi) { unsigned r; asm volatile("v_cvt_pk_bf16_f32 %0, %1, %2" : "=v"(r) : "v"(lo), "v"(hi)); return r; }
typedef float f32x2 __attribute__((ext_vector_type(2)));
typedef unsigned u32x2 __attribute__((ext_vector_type(2)));
constexpr float LOG2E = 1.4426950408889634f;
constexpr float NORM_EPS = 1e-6f;
__device__ __forceinline__ float sigm(float x) { return __builtin_amdgcn_rcpf(1.0f + __builtin_amdgcn_exp2f(-x * LOG2E)); }
__device__ __forceinline__ float bflo(unsigned w) { return __builtin_bit_cast(float, w << 16); }
__device__ __forceinline__ float bfhi(unsigned w) { return __builtin_bit_cast(float, w & 0xffff0000u); }

struct EpiInProj {
    static constexpr bool PERM = true, AFTER_DRAIN = false;
    bf16_t *QA, *KA, *VA, *QKVB, *GA, *GB; const float* b_gate; float qb_scale;
    __device__ __forceinline__ void operator()(const f32x4 (&acc)[2][2][4][2], const Unit& u, int wr, int wc, int fr, int fq) const {
        const int colt = u.pn * BM;
        bf16_t* base; int ldc, c0; bool gate = false; float sc = 1.f;
        if (colt < 1024)      { base = QA; ldc = 1024; c0 = colt; }
        else if (colt < 1280) { base = KA; ldc = 256; c0 = 0; }
        else if (colt < 1536) { base = VA; ldc = 256; c0 = 0; }
        else if (colt < 3840) { base = QKVB; ldc = 2304; c0 = colt - 1536; if (colt < 2304) sc = qb_scale; }
        else if (colt < 4864) { base = GA; ldc = 1024; c0 = colt - 3840; gate = true; }
        else                  { base = GB; ldc = 1024; c0 = colt - 4864; gate = true; }
        const int row0 = u.pm * BM + wr * 64 + fr, col0 = c0 + wc * 32 + 8 * fq;
        f32x4 bv[2][2];
#pragma unroll
        for (int bj = 0; bj < 2; ++bj)
#pragma unroll
            for (int n = 0; n < 2; ++n) bv[bj][n] = gate ? *(const f32x4*)(b_gate + (colt - 3840) + wc * 32 + 8 * fq + bj * HALF + 4 * n) : (f32x4){0.f, 0.f, 0.f, 0.f};
#pragma unroll
        for (int ai = 0; ai < 2; ++ai)
#pragma unroll
            for (int m = 0; m < 4; ++m) { bf16_t* rowp = base + (size_t)(row0 + ai * HALF + m * 16) * ldc + col0;
#pragma unroll
                for (int bj = 0; bj < 2; ++bj) { f32x4 v0 = acc[ai][bj][m][0] + bv[bj][0], v1 = acc[ai][bj][m][1] + bv[bj][1];
                    if (gate) { v0 = (f32x4){sigm(v0[0]), sigm(v0[1]), sigm(v0[2]), sigm(v0[3])}; v1 = (f32x4){sigm(v1[0]), sigm(v1[1]), sigm(v1[2]), sigm(v1[3])}; }
                    else { v0 = v0 * sc; v1 = v1 * sc; }
                    u32x4 w; w.x = cvt_pk_bf16(v0[0], v0[1]); w.y = cvt_pk_bf16(v0[2], v0[3]); w.z = cvt_pk_bf16(v1[0], v1[1]); w.w = cvt_pk_bf16(v1[2], v1[3]);
                    *(u32x4*)(rowp + bj * HALF) = w; } }
    }
};
struct EpiGateMul {
    static constexpr bool PERM = false, AFTER_DRAIN = false;
    const bf16_t* G; float* U;
    __device__ __forceinline__ void operator()(const f32x4 (&acc)[2][2][4][2], const Unit& u, int wr, int wc, int fr, int fq) const {
        const int row0 = u.pm * BM + wr * 64 + fr, col0 = u.pn * BM + wc * 32 + 4 * fq;
#pragma unroll
        for (int ai = 0; ai < 2; ++ai)
#pragma unroll
            for (int m = 0; m < 4; ++m) { const size_t off = (size_t)(row0 + ai * HALF + m * 16) * 1024 + col0;
#pragma unroll
                for (int bj = 0; bj < 2; ++bj)
#pragma unroll
                    for (int n = 0; n < 2; ++n) { const size_t o2 = off + bj * HALF + n * 16; const u32x2 g = *(const u32x2*)(G + o2);
                        const f32x4 gv = {bflo(g.x), bfhi(g.x), bflo(g.y), bfhi(g.y)}; *(f32x4*)(U + o2) = gv * acc[ai][bj][m][n]; } }
    }
};
struct EpiGateAdd {
    static constexpr bool PERM = true, AFTER_DRAIN = false;
    const bf16_t* G; const float* U; bf16_t* O;
    __device__ __forceinline__ void operator()(const f32x4 (&acc)[2][2][4][2], const Unit& u, int wr, int wc, int fr, int fq) const {
        const int row0 = u.pm * BM + wr * 64 + fr, col0 = u.pn * BM + wc * 32 + 8 * fq;
#pragma unroll
        for (int ai = 0; ai < 2; ++ai)
#pragma unroll
            for (int m = 0; m < 4; ++m) { const size_t off = (size_t)(row0 + ai * HALF + m * 16) * 1024 + col0;
#pragma unroll
                for (int bj = 0; bj < 2; ++bj) { const size_t o2 = off + bj * HALF; const u32x4 g = *(const u32x4*)(G + o2);
                    const f32x4 u0 = *(const f32x4*)(U + o2), u1 = *(const f32x4*)(U + o2 + 4);
                    const f32x4 g0 = {bflo(g.x), bfhi(g.x), bflo(g.y), bfhi(g.y)}, g1 = {bflo(g.z), bfhi(g.z), bflo(g.w), bfhi(g.w)};
                    const f32x4 v0 = u0 + g0 * acc[ai][bj][m][0], v1 = u1 + g1 * acc[ai][bj][m][1];
                    u32x4 w; w.x = cvt_pk_bf16(v0[0], v0[1]); w.y = cvt_pk_bf16(v0[2], v0[3]); w.z = cvt_pk_bf16(v1[0], v1[1]); w.w = cvt_pk_bf16(v1[2], v1[3]);
                    *(u32x4*)(O + o2) = w; } }
    }
};
struct EpiResid {
    static constexpr bool PERM = false, AFTER_DRAIN = false;
    const float* base; float* out; bf16_t* outb; float* ssq;
    __device__ __forceinline__ void operator()(const f32x4 (&acc)[2][2][4][2], const Unit& u, int wr, int wc, int fr, int fq) const {
        const int row0 = u.pm * BM + wr * 64 + fr, col0 = u.pn * BM + wc * 32 + 4 * fq;
#pragma unroll
        for (int ai = 0; ai < 2; ++ai)
#pragma unroll
            for (int m = 0; m < 4; ++m) { const int row = row0 + ai * HALF + m * 16; const size_t off = (size_t)row * 1024 + col0; float s = 0.f;
#pragma unroll
                for (int bj = 0; bj < 2; ++bj)
#pragma unroll
                    for (int n = 0; n < 2; ++n) { const size_t o2 = off + bj * HALF + n * 16; const f32x4 o = *(const f32x4*)(base + o2) + acc[ai][bj][m][n];
                        *(f32x4*)(out + o2) = o; u32x2 w; w.x = cvt_pk_bf16(o[0], o[1]); w.y = cvt_pk_bf16(o[2], o[3]); *(u32x2*)(outb + o2) = w;
                        s += (o[0] * o[0] + o[1] * o[1]) + (o[2] * o[2] + o[3] * o[3]); }
                s += __shfl_xor(s, 16); s += __shfl_xor(s, 32);
                if (fq == 0) atomicAdd(ssq + row, s); }
    }
};
struct EpiFF1 {
    static constexpr bool PERM = true, AFTER_DRAIN = false;
    bf16_t* H; const float* ssq;
    __device__ __forceinline__ void operator()(const f32x4 (&acc)[2][2][4][2], const Unit& u, int wr, int wc, int fr, int fq) const {
        const int row0 = u.pm * BM + wr * 64 + fr, col0 = u.pn * BM + wc * 32 + 8 * fq;
#pragma unroll
        for (int ai = 0; ai < 2; ++ai)
#pragma unroll
            for (int m = 0; m < 4; ++m) { const int row = row0 + ai * HALF + m * 16; const float rstd = __builtin_amdgcn_rsqf(ssq[row] * (1.0f / 1024.0f) + NORM_EPS);
                bf16_t* rowp = H + (size_t)row * 4096 + col0;
#pragma unroll
                for (int bj = 0; bj < 2; ++bj) { f32x4 v0 = acc[ai][bj][m][0] * rstd, v1 = acc[ai][bj][m][1] * rstd;
#pragma unroll
                    for (int e = 0; e < 4; ++e) { const float a = fmaxf(v0[e], 0.f), b = fmaxf(v1[e], 0.f); v0[e] = a * a; v1[e] = b * b; }
                    u32x4 w; w.x = cvt_pk_bf16(v0[0], v0[1]); w.y = cvt_pk_bf16(v0[2], v0[3]); w.z = cvt_pk_bf16(v1[0], v1[1]); w.w = cvt_pk_bf16(v1[2], v1[3]);
                    *(u32x4*)(rowp + bj * HALF) = w; } }
    }
};
struct EpiStoreF32 {
    static constexpr bool PERM = false, AFTER_DRAIN = false;
    float* C;
    __device__ __forceinline__ void operator()(const f32x4 (&acc)[2][2][4][2], const Unit& u, int wr, int wc, int fr, int fq) const {
        const int row0 = u.pm * BM + wr * 64 + fr, col0 = u.pn * BM + wc * 32 + 4 * fq;
#pragma unroll
        for (int ai = 0; ai < 2; ++ai)
#pragma unroll
            for (int m = 0; m < 4; ++m) { float* rowp = C + (size_t)(row0 + ai * HALF + m * 16) * 1024 + col0;
#pragma unroll
                for (int bj = 0; bj < 2; ++bj)
#pragma unroll
                    for (int n = 0; n < 2; ++n) *(f32x4*)(rowp + bj * HALF + n * 16) = acc[ai][bj][m][n]; }
    }
};
struct EpiPle {
    static constexpr bool PERM = false, AFTER_DRAIN = false;
    float* X; const float* PE; const float* ssq_in; float* ssq_out;
    __device__ __forceinline__ void operator()(const f32x4 (&acc)[2][2][4][2], const Unit& u, int wr, int wc, int fr, int fq) const {
        const int row0 = u.pm * BM + wr * 64 + fr, col0 = u.pn * BM + wc * 32 + 4 * fq;
#pragma unroll
        for (int ai = 0; ai < 2; ++ai)
#pragma unroll
            for (int m = 0; m < 4; ++m) { const int row = row0 + ai * HALF + m * 16; const size_t off = (size_t)row * 1024 + col0; float s = 0.f;
                const float rstd = __builtin_amdgcn_rsqf(ssq_in[row] * (1.0f / 1024.0f) + NORM_EPS);
#pragma unroll
                for (int bj = 0; bj < 2; ++bj)
#pragma unroll
                    for (int n = 0; n < 2; ++n) { const size_t o2 = off + bj * HALF + n * 16; const f32x4 a = acc[ai][bj][m][n] * rstd;
                        const f32x4 g = {sigm(a[0]), sigm(a[1]), sigm(a[2]), sigm(a[3])};
                        const f32x4 o = *(const f32x4*)(X + o2) + g * *(const f32x4*)(PE + o2);
                        *(f32x4*)(X + o2) = o; s += (o[0] * o[0] + o[1] * o[1]) + (o[2] * o[2] + o[3] * o[3]); }
                s += __shfl_xor(s, 16); s += __shfl_xor(s, 32);
                if (fq == 0) atomicAdd(ssq_out + row, s); }
    }
};

template <class Epi, class Sched, bool ALIGN_EPI = false, bool SP2 = false>
__device__ __forceinline__ void gemm_phase(PG8_LAS unsigned char* lds, const Gemm g, const Sched& S, const Epi& E) {
    int tid_ = threadIdx.x; asm volatile("" : "+v"(tid_));
    const int tid = tid_, wid = __builtin_amdgcn_readfirstlane(tid >> 6), lane = tid & 63, wr = wid >> 2, wc = wid & 3, fr = lane & 15, fq = lane >> 4;
    const int K = g.K, nt = K / BK;
    unsigned voffA[2], voffB[2];
#pragma unroll
    for (int i = 0; i < 2; ++i) { int R, C; stage_rc(tid * 16 + i * 8192, R, C); const int Rb = Epi::PERM ? ((R & ~31) + perm32(R & 31)) : R;
        voffA[i] = (unsigned)(R * K + C) * 2u; voffB[i] = (unsigned)(Rb * K + C) * 2u; }
    const size_t kstep = (size_t)(BK * 2);
    const size_t hstep = (size_t)HALF * K * 2;
    const size_t tstep = 2 * hstep;
    const unsigned ldsw = (unsigned)wid * 1024u;
    const int aoff = lds_byte(wr * 64 + fr, fq * 8), boff = lds_byte(wc * 32 + fr, fq * 8);
#define PG8_SA(b, h) (((b) * 2 + (h)) * HTB)
#define PG8_SB(b, h) ((4 + (b) * 2 + (h)) * HTB)
#define PG8_STAGE(bufoff, gbase, voff) do { _Pragma("unroll") for (int _i = 0; _i < 2; ++_i) \
        __builtin_amdgcn_global_load_lds((const unsigned*)((const char*)(gbase) + (voff)[_i]), (PG8_LAS unsigned*)(lds + (bufoff) + ldsw + _i * 8192), 16, 0, 0); } while (0)
#define PG8_LDA(dst, b, h) do { _Pragma("unroll") for (int m = 0; m < 4; ++m) _Pragma("unroll") for (int k = 0; k < 2; ++k) dst[m][k] = *(const PG8_LAS bf16x8*)(lds + PG8_SA(b, h) + aoff + m * 2048 + k * 1024); } while (0)
#define PG8_LDB(dst, b, h) do { _Pragma("unroll") for (int n = 0; n < 2; ++n) _Pragma("unroll") for (int k = 0; k < 2; ++k) dst[n][k] = *(const PG8_LAS bf16x8*)(lds + PG8_SB(b, h) + boff + n * 2048 + k * 1024); } while (0)
#define PG8_MMA(ai, bj, At, Bt) do { __builtin_amdgcn_s_setprio(1); _Pragma("unroll") for (int m = 0; m < 4; ++m) _Pragma("unroll") for (int n = 0; n < 2; ++n) _Pragma("unroll") for (int k = 0; k < 2; ++k) \
        acc[ai][bj][m][n] = __builtin_amdgcn_mfma_f32_16x16x32_bf16(Bt[n][k], At[m][k], acc[ai][bj][m][n], 0, 0, 0); __builtin_amdgcn_s_setprio(0); } while (0)
#define PG8_WAIT_V(n) asm volatile("s_waitcnt vmcnt(" #n ")" ::: "memory")
#define PG8_WAIT_L(n) asm volatile("s_waitcnt lgkmcnt(" #n ")" ::: "memory")
#define PG8_BAR __builtin_amdgcn_s_barrier()
#define PG8_SCHED __builtin_amdgcn_sched_barrier(0)
    Unit cur, nxt; int ui = 0;
    if (!S.next(0, cur)) return;
    f32x4 acc[2][2][4][2];
#pragma unroll
    for (int a = 0; a < 2; ++a)
#pragma unroll
        for (int b = 0; b < 2; ++b)
#pragma unroll
            for (int m = 0; m < 4; ++m)
#pragma unroll
                for (int n = 0; n < 2; ++n) acc[a][b][m][n] = (f32x4){0.f, 0.f, 0.f, 0.f};
    bf16x8 At[4][2], B0[2][2], B1[2][2];
    const char* cA = (const char*)g.A + (size_t)cur.pm * tstep; const char* cB = (const char*)g.Bt + (size_t)cur.pn * tstep;
    S.a_ready(cur);
    if constexpr (SP2) {
        PG8_STAGE(PG8_SB(0, 0), cB, voffB); PG8_STAGE(PG8_SB(0, 1), cB + hstep, voffB); PG8_STAGE(PG8_SA(0, 0), cA, voffA); PG8_STAGE(PG8_SA(0, 1), cA + hstep, voffA);
        if (wr == 1) PG8_BAR;
        PG8_WAIT_V(2); PG8_BAR;
        PG8_STAGE(PG8_SB(1, 0), cB + kstep, voffB); PG8_STAGE(PG8_SA(1, 0), cA + kstep, voffA); PG8_STAGE(PG8_SB(1, 1), cB + hstep + kstep, voffB);
        PG8_WAIT_V(6); PG8_BAR;
    } else {
        PG8_STAGE(PG8_SB(0, 0), cB, voffB); PG8_STAGE(PG8_SA(0, 0), cA, voffA); PG8_STAGE(PG8_SB(0, 1), cB + hstep, voffB); PG8_STAGE(PG8_SA(0, 1), cA + hstep, voffA);
        if (wr == 1) PG8_BAR;
        PG8_WAIT_V(4); PG8_BAR;
        PG8_STAGE(PG8_SB(1, 0), cB + kstep, voffB); PG8_STAGE(PG8_SA(1, 0), cA + kstep, voffA); PG8_STAGE(PG8_SB(1, 1), cB + hstep + kstep, voffB);
        PG8_WAIT_V(6); PG8_BAR;
    }
    for (;;) {
        const bool has_next = S.next(ui + 1, nxt);
        const char* nA = has_next ? (const char*)g.A + (size_t)nxt.pm * tstep : cA; const char* nB = has_next ? (const char*)g.Bt + (size_t)nxt.pn * tstep : cB;
        for (int t = 0; t < nt; t += 2) {
            const bool last = (t == nt - 2);
            const char* a1 = cA + (size_t)(t + 1) * kstep;
            const char* a2 = last ? nA : cA + (size_t)(t + 2) * kstep; const char* b2 = last ? nB : cB + (size_t)(t + 2) * kstep;
            const char* a3 = a2 + kstep; const char* b3 = b2 + kstep;
            if (last && has_next) S.a_ready(nxt);
            if constexpr (SP2) {
            PG8_LDB(B0, 0, 0); PG8_LDB(B1, 0, 1); PG8_SCHED; PG8_LDA(At, 0, 0); PG8_STAGE(PG8_SA(1, 1), a1 + hstep, voffA);
            PG8_WAIT_V(8); PG8_WAIT_L(0); PG8_BAR; PG8_MMA(0, 0, At, B0); PG8_MMA(0, 1, At, B1); PG8_BAR; PG8_SCHED;
            PG8_LDA(At, 0, 1); PG8_STAGE(PG8_SB(0, 0), b2, voffB); PG8_STAGE(PG8_SB(0, 1), b2 + hstep, voffB); PG8_STAGE(PG8_SA(0, 0), a2, voffA);
            PG8_WAIT_V(8); PG8_WAIT_L(0); PG8_BAR; PG8_MMA(1, 0, At, B0); PG8_MMA(1, 1, At, B1); PG8_BAR; PG8_SCHED;
            PG8_LDB(B0, 1, 0); PG8_LDB(B1, 1, 1); PG8_SCHED; PG8_LDA(At, 1, 0); PG8_STAGE(PG8_SA(0, 1), a2 + hstep, voffA);
            PG8_WAIT_V(8); PG8_WAIT_L(0); PG8_BAR; PG8_MMA(0, 0, At, B0); PG8_MMA(0, 1, At, B1); PG8_BAR; PG8_SCHED;
            PG8_LDA(At, 1, 1); PG8_STAGE(PG8_SB(1, 0), b3, voffB); PG8_STAGE(PG8_SB(1, 1), b3 + hstep, voffB); PG8_STAGE(PG8_SA(1, 0), a3, voffA);
            PG8_WAIT_V(8); PG8_WAIT_L(0); PG8_BAR; PG8_MMA(1, 0, At, B0); PG8_MMA(1, 1, At, B1); PG8_BAR; PG8_SCHED;
            } else {
            PG8_LDB(B0, 0, 0); PG8_SCHED; PG8_LDA(At, 0, 0); PG8_STAGE(PG8_SA(1, 1), a1 + hstep, voffA);
            PG8_WAIT_L(8); PG8_BAR; PG8_WAIT_L(0); PG8_MMA(0, 0, At, B0); PG8_BAR; PG8_SCHED;
            PG8_LDB(B1, 0, 1); PG8_STAGE(PG8_SB(0, 0), b2, voffB);
            PG8_BAR; PG8_WAIT_L(0); PG8_MMA(0, 1, At, B1); PG8_BAR;
            PG8_LDA(At, 0, 1); PG8_STAGE(PG8_SA(0, 0), a2, voffA);
            PG8_BAR; PG8_WAIT_L(0); PG8_MMA(1, 0, At, B0); PG8_BAR; PG8_SCHED;
            PG8_STAGE(PG8_SB(0, 1), b2 + hstep, voffB);
            PG8_WAIT_V(6); PG8_BAR; PG8_MMA(1, 1, At, B1); PG8_BAR;
            PG8_LDB(B0, 1, 0); PG8_SCHED; PG8_LDA(At, 1, 0); PG8_STAGE(PG8_SA(0, 1), a2 + hstep, voffA);
            PG8_WAIT_L(8); PG8_BAR; PG8_WAIT_L(0); PG8_MMA(0, 0, At, B0); PG8_BAR; PG8_SCHED;
            PG8_LDB(B1, 1, 1); PG8_STAGE(PG8_SB(1, 0), b3, voffB);
            PG8_BAR; PG8_WAIT_L(0); PG8_MMA(0, 1, At, B1); PG8_BAR;
            PG8_LDA(At, 1, 1); PG8_STAGE(PG8_SA(1, 0), a3, voffA);
            PG8_BAR; PG8_WAIT_L(0); PG8_MMA(1, 0, At, B0); PG8_BAR; PG8_SCHED;
            PG8_STAGE(PG8_SB(1, 1), b3 + hstep, voffB);
            PG8_WAIT_V(6); PG8_BAR; PG8_MMA(1, 1, At, B1); PG8_BAR;
            }
        }
        if constexpr (ALIGN_EPI) { if (wr == 0) PG8_BAR; }
        if constexpr (!Epi::AFTER_DRAIN) { E(acc, cur, wr, wc, fr, fq); S.done(cur); }
        if (!has_next) break;
#pragma unroll
        for (int a = 0; a < 2; ++a)
#pragma unroll
            for (int b = 0; b < 2; ++b)
#pragma unroll
                for (int m = 0; m < 4; ++m)
#pragma unroll
                    for (int n = 0; n < 2; ++n) acc[a][b][m][n] = (f32x4){0.f, 0.f, 0.f, 0.f};
        cur = nxt; cA = nA; cB = nB; ++ui;
        if constexpr (ALIGN_EPI) { if (wr == 1) PG8_BAR; }
    }
    PG8_WAIT_V(0);
    if constexpr (!ALIGN_EPI) { if (wr == 0) PG8_BAR; }
    PG8_BAR;
    if constexpr (Epi::AFTER_DRAIN) { E.fused(acc, cur, wr, wc, fr, fq, lds, wid, lane); S.done(cur); }
#undef PG8_SA
#undef PG8_SB
#undef PG8_STAGE
#undef PG8_LDA
#undef PG8_LDB
#undef PG8_MMA
#undef PG8_WAIT_V
#undef PG8_WAIT_L
#undef PG8_BAR
#undef PG8_SCHED
}
}
namespace attnA {
using bf16 = __hip_bfloat16;
constexpr int   D = 128, NW = 8, QBLK = 32, KVBLK = 64;
constexpr float SCALE = 0.088388347648318440f;
constexpr float THR = 8.f;
constexpr int LDQ = 1024, LDK = 256, LDO = 1024;
constexpr size_t SHM_V = KVBLK * D * 2, SHM_K = KVBLK * D * 2, SHM_ATTN = 2 * SHM_V + 2 * SHM_K + NW * 64 * 4;
using bf16x8 = __attribute__((ext_vector_type(8))) short;
using s16x4  = __attribute__((ext_vector_type(4))) short;
using f32x16 = __attribute__((ext_vector_type(16))) float;
using u32x4  = __attribute__((ext_vector_type(4))) unsigned;
#define KSWZ(row, colB) ((row) * 256 + ((colB) ^ (((row) & 7) << 4)))
#define SBAR() __builtin_amdgcn_sched_barrier(0)
__device__ __forceinline__ int crow(int r, int hi) { return (r & 3) + 8 * (r >> 2) + 4 * hi; }
__device__ __forceinline__ unsigned cvtpk(float lo, float hi) { unsigned r; asm volatile("v_cvt_pk_bf16_f32 %0, %1, %2" : "=v"(r) : "v"(lo), "v"(hi)); return r; }
__device__ __forceinline__ bf16x8 ld8(const bf16* p) { return *reinterpret_cast<const bf16x8*>(p); }

__device__ __forceinline__ void partialSM(f32x16& p0, f32x16& p1, float& m_reg, float& mn, float& alpha) {
  constexpr float C = SCALE * 1.4426950408889634f;
  float pmax = p0[0];
#pragma unroll
  for (int r = 1; r < 16; ++r) pmax = fmaxf(pmax, p0[r]);
#pragma unroll
  for (int r = 0; r < 16; ++r) pmax = fmaxf(pmax, p1[r]);
  { auto rr = __builtin_amdgcn_permlane32_swap(__float_as_uint(pmax), __float_as_uint(pmax), false, false);
    pmax = fmaxf(__uint_as_float(rr[0]), __uint_as_float(rr[1])); }
  if (__builtin_expect(__all(pmax - m_reg <= THR / SCALE), 1)) { mn = m_reg; alpha = 1.f; }
  else { mn = fmaxf(m_reg, pmax); alpha = __builtin_amdgcn_exp2f((m_reg - mn) * C); m_reg = mn; }
  float mnC = -mn * C;
#pragma unroll
  for (int r = 0; r < 16; ++r) p0[r] = fmaf(p0[r], C, mnC);
#pragma unroll
  for (int r = 0; r < 16; ++r) p1[r] = fmaf(p1[r], C, mnC);
#pragma unroll
  for (int r = 0; r < 16; ++r) p0[r] = __builtin_amdgcn_exp2f(p0[r]);
}
__device__ __forceinline__ void finishSM(f32x16& p0, f32x16& p1, float alpha, float& l_reg, bf16x8& pa0, bf16x8& pa1, bf16x8& pa2, bf16x8& pa3) {
#pragma unroll
  for (int r = 0; r < 16; ++r) p1[r] = __builtin_amdgcn_exp2f(p1[r]);
  float ps = 0;
#pragma unroll
  for (int r = 0; r < 16; ++r) ps += p0[r];
#pragma unroll
  for (int r = 0; r < 16; ++r) ps += p1[r];
  { auto rr = __builtin_amdgcn_permlane32_swap(__float_as_uint(ps), __float_as_uint(ps), false, false);
    ps = __uint_as_float(rr[0]) + __uint_as_float(rr[1]); }
  l_reg = l_reg * alpha + ps;
#define PK4(P, BASE, OUT) do { unsigned a0 = cvtpk(P[BASE + 0], P[BASE + 1]), a1 = cvtpk(P[BASE + 2], P[BASE + 3]);   \
    unsigned b0 = cvtpk(P[BASE + 4], P[BASE + 5]), b1 = cvtpk(P[BASE + 6], P[BASE + 7]);                              \
    auto r0 = __builtin_amdgcn_permlane32_swap(a0, b0, false, false); auto r1 = __builtin_amdgcn_permlane32_swap(a1, b1, false, false); \
    u32x4 w = {r0[0], r1[0], r0[1], r1[1]}; OUT = *reinterpret_cast<bf16x8*>(&w); } while (0)
  PK4(p0, 0, pa0); PK4(p0, 8, pa1); PK4(p1, 0, pa2); PK4(p1, 8, pa3);
#undef PK4
}
__device__ __forceinline__ void qkt(f32x16& p0, f32x16& p1, const bf16* Ks, const bf16x8* qr, int r32, int hi) {
  p0 = f32x16{}; p1 = f32x16{};
#pragma unroll
  for (int d0 = 0; d0 < 8; ++d0) { int cb = (d0 * 16 + hi * 8) * 2;
    bf16x8 b0 = *reinterpret_cast<const bf16x8*>((const char*)Ks + KSWZ(r32, cb));
    bf16x8 b1 = *reinterpret_cast<const bf16x8*>((const char*)Ks + KSWZ(32 + r32, cb));
    p0 = __builtin_amdgcn_mfma_f32_32x32x16_bf16(b0, qr[d0], p0, 0, 0, 0);
    p1 = __builtin_amdgcn_mfma_f32_32x32x16_bf16(b1, qr[d0], p1, 0, 0, 0); }
}
__device__ __forceinline__ int v_st(int k, int c) { const int kk = (k & ~0xC) | ((k & 4) << 1) | ((k & 8) >> 1); return ((kk >> 3) * 4 + (c >> 5)) * 512 + ((kk & 7) * 32 + (c & 31)) * 2; }
__device__ __forceinline__ int v_rd_base(int lane) { return ((lane & 3) << 3) | (((lane >> 2) & 3) << 6) | (((lane >> 4) & 1) << 5) | (((lane >> 5) & 1) << 8); }
constexpr int v_rd_off(int d0, int ks, int half) { return d0 * 512 + ks * 4096 + half * 2048; }
template <int OFF> __device__ __forceinline__ s16x4 tr_read(int vb) {
  s16x4 r; asm volatile("ds_read_b64_tr_b16 %0, %1 offset:%2" : "=&v"(r) : "v"(vb), "i"(OFF) : "memory"); return r;
}
template <int D0> __device__ __forceinline__ void pv_one(f32x16& od, int vb, bf16x8 pa0, bf16x8 pa1, bf16x8 pa2, bf16x8 pa3) {
  const s16x4 l0 = tr_read<v_rd_off(D0, 0, 0)>(vb), h0 = tr_read<v_rd_off(D0, 0, 1)>(vb), l1 = tr_read<v_rd_off(D0, 1, 0)>(vb), h1 = tr_read<v_rd_off(D0, 1, 1)>(vb);
  const s16x4 l2 = tr_read<v_rd_off(D0, 2, 0)>(vb), h2 = tr_read<v_rd_off(D0, 2, 1)>(vb), l3 = tr_read<v_rd_off(D0, 3, 0)>(vb), h3 = tr_read<v_rd_off(D0, 3, 1)>(vb);
  asm volatile("s_waitcnt lgkmcnt(0)" ::: "memory"); SBAR();
#define PK(L, H) (bf16x8){L[0], L[1], L[2], L[3], H[0], H[1], H[2], H[3]}
  od = __builtin_amdgcn_mfma_f32_32x32x16_bf16(pa0, PK(l0, h0), od, 0, 0, 0);
  od = __builtin_amdgcn_mfma_f32_32x32x16_bf16(pa1, PK(l1, h1), od, 0, 0, 0);
  od = __builtin_amdgcn_mfma_f32_32x32x16_bf16(pa2, PK(l2, h2), od, 0, 0, 0);
  od = __builtin_amdgcn_mfma_f32_32x32x16_bf16(pa3, PK(l3, h3), od, 0, 0, 0);
#undef PK
}
__device__ __forceinline__ void pv_d0(f32x16* o, int vb, bf16x8 pa0, bf16x8 pa1, bf16x8 pa2, bf16x8 pa3) {
  pv_one<0>(o[0], vb, pa0, pa1, pa2, pa3); pv_one<1>(o[1], vb, pa0, pa1, pa2, pa3); pv_one<2>(o[2], vb, pa0, pa1, pa2, pa3); pv_one<3>(o[3], vb, pa0, pa1, pa2, pa3);
}
__device__ __forceinline__ void attn_dense_body(const bf16* Qb, const bf16* __restrict__ Kh, const bf16* __restrict__ Vh, bf16* Ob, int seq, char* lds) {
  constexpr int SDEPTH = 2;
  int tid_ = threadIdx.x; asm volatile("" : "+v"(tid_));
  const int tid = tid_, wid = tid >> 6, lane = tid & 63, r32 = lane & 31, hi = lane >> 5;
  bf16* V_lds = (bf16*)lds; bf16* K_lds = (bf16*)(lds + 2 * SHM_V);
  float* ws = (float*)(lds + 2 * SHM_V + 2 * SHM_K) + wid * 64; float* li_l = ws; float* al_l = ws + 32;
  float m_reg = -1e30f, l_reg = 0; f32x16 o[4] = {}; bf16x8 qr[8];
  const bf16* Qw = Qb + (long)(wid * QBLK + r32) * LDQ + hi * 8;
#pragma unroll
  for (int d0 = 0; d0 < 8; ++d0) qr[d0] = ld8(Qw + d0 * 16);
  const int sr = tid >> 4, sc = (tid & 15) * 8, vst0 = v_st(sr, sc), vst1 = v_st(32 + sr, sc);
  const int vb0 = (int)(uintptr_t)V_lds + v_rd_base(lane);
  struct { bf16x8 vs0, vs1, ks0, ks1; } sr_[SDEPTH];
#define SLOAD(i, k0) do { sr_[i].vs0 = ld8(&Vh[(long)((k0) + sr) * LDK + sc]); sr_[i].vs1 = ld8(&Vh[(long)((k0) + 32 + sr) * LDK + sc]); \
    sr_[i].ks0 = ld8(&Kh[(long)((k0) + sr) * LDK + sc]); sr_[i].ks1 = ld8(&Kh[(long)((k0) + 32 + sr) * LDK + sc]); } while (0)
#define SWRITE(b, i) do { *(bf16x8*)((char*)V_lds + (b) * SHM_V + vst0) = sr_[i].vs0;          \
    *(bf16x8*)((char*)V_lds + (b) * SHM_V + vst1) = sr_[i].vs1; int kc = sc * 2;               \
    *(bf16x8*)((char*)K_lds + (b) * SHM_K + KSWZ(sr, kc)) = sr_[i].ks0;                       \
    *(bf16x8*)((char*)K_lds + (b) * SHM_K + KSWZ(32 + sr, kc)) = sr_[i].ks1; } while (0)
#define SWAIT() do { asm volatile("s_waitcnt vmcnt(4)" ::: "memory"); } while (0)
#define RESC(a) do { if (__any((a) < 1.f)) { if (hi == 0) al_l[r32] = (a); asm volatile("s_waitcnt lgkmcnt(0)" ::: "memory"); \
    _Pragma("unroll") for (int d = 0; d < 4; ++d) _Pragma("unroll") for (int r = 0; r < 16; ++r) o[d][r] *= al_l[crow(r, hi)]; } } while (0)
  f32x16 pA0, pA1, pB0, pB1; float mnA, mnB, alA, alB; bf16x8 pa0, pa1, pa2, pa3; const int NT = seq / KVBLK;
  constexpr int SE = 0, SO = SDEPTH - 1;
  SLOAD(SE, 0); asm volatile("s_waitcnt vmcnt(0)" ::: "memory"); SWRITE(0, SE); __syncthreads();
  qkt(pA0, pA1, K_lds, qr, r32, hi); partialSM(pA0, pA1, m_reg, mnA, alA);
  SLOAD(SO, KVBLK); if (2 < NT) SLOAD(SE, 2 * KVBLK);
  SWAIT(); SWRITE(1, SO); __syncthreads();
  for (int j = 1; j + 1 < NT; j += 2) {
    SBAR(); qkt(pB0, pB1, (bf16*)((char*)K_lds + SHM_K), qr, r32, hi);
    finishSM(pA0, pA1, alA, l_reg, pa0, pa1, pa2, pa3); SBAR();
    SLOAD(SO, (j + SDEPTH) * KVBLK); SBAR();
    pv_d0(o, vb0, pa0, pa1, pa2, pa3); partialSM(pB0, pB1, m_reg, mnB, alB);
    __syncthreads(); SWAIT(); SWRITE(0, SE);
    RESC(alB); __syncthreads();
    SBAR(); qkt(pA0, pA1, K_lds, qr, r32, hi);
    finishSM(pB0, pB1, alB, l_reg, pa0, pa1, pa2, pa3); SBAR();
    if (j + 3 < NT) SLOAD(SE, (j + 1 + SDEPTH) * KVBLK); SBAR();
    pv_d0(o, vb0 + (int)SHM_V, pa0, pa1, pa2, pa3); partialSM(pA0, pA1, m_reg, mnA, alA);
    __syncthreads(); SWAIT(); SWRITE(1, SO);
    RESC(alA); __syncthreads();
  }
  SBAR(); qkt(pB0, pB1, (bf16*)((char*)K_lds + SHM_K), qr, r32, hi);
  finishSM(pA0, pA1, alA, l_reg, pa0, pa1, pa2, pa3); SBAR();
  pv_d0(o, vb0, pa0, pa1, pa2, pa3); partialSM(pB0, pB1, m_reg, mnB, alB);
  __syncthreads(); RESC(alB);
  finishSM(pB0, pB1, alB, l_reg, pa0, pa1, pa2, pa3); SBAR();
  pv_d0(o, vb0 + (int)SHM_V, pa0, pa1, pa2, pa3);
  if (hi == 0) li_l[r32] = l_reg; asm volatile("s_waitcnt lgkmcnt(0)" ::: "memory");
  float rli[16];
#pragma unroll
  for (int r = 0; r < 16; ++r) rli[r] = __builtin_amdgcn_rcpf(li_l[crow(r, hi)]);
  unsigned short* Ow = (unsigned short*)Ob + (long)(wid * QBLK) * LDO;
#pragma unroll
  for (int r = 0; r < 16; ++r) { int orow = crow(r, hi);
#pragma unroll
    for (int d0 = 0; d0 < 4; d0 += 2) { const unsigned w = cvtpk(o[d0][r] * rli[r], o[d0 + 1][r] * rli[r]);
      Ow[(long)orow * LDO + d0 * 32 + r32] = (unsigned short)(w & 0xffffu); Ow[(long)orow * LDO + (d0 + 1) * 32 + r32] = (unsigned short)(w >> 16); } }
#undef SLOAD
#undef SWRITE
#undef SWAIT
#undef RESC
}
#undef KSWZ
#undef SBAR
}

namespace attnB {
#define LASB __attribute__((address_space(3)))
using bf16x8 = __attribute__((ext_vector_type(8))) short;
using s16x4  = __attribute__((ext_vector_type(4))) short;
using f32x16 = __attribute__((ext_vector_type(16))) float;
using u32x4  = __attribute__((ext_vector_type(4))) unsigned;
typedef short v4i16_t __attribute__((ext_vector_type(4)));
constexpr int PITCH = 2304, S = 8192, VSTR = 144;
constexpr int OST = 0, MST = 65536, LST = 66560, BIAS = 67584, WSCR = 69632, WSZ = 32 * VSTR + 256, LDS_BYTES = WSCR + 8 * WSZ;
__device__ __forceinline__ int crow(int r, int hi) { return (r & 3) + 8 * (r >> 2) + 4 * hi; }
__device__ __forceinline__ unsigned cvtpk(float lo, float hi) { unsigned r; asm volatile("v_cvt_pk_bf16_f32 %0, %1, %2" : "=v"(r) : "v"(lo), "v"(hi)); return r; }
__device__ __forceinline__ s16x4 vtr(const LASB char* p) { return __builtin_bit_cast(s16x4, __builtin_amdgcn_ds_read_tr16_b64_v4i16((LASB v4i16_t*)p)); }
__device__ __forceinline__ int t5_bucket(int rel) {
  const int n = rel < 0 ? -rel : rel; int bk;
  if (n < 8) bk = n; else bk = 8 + (n >= 15) + (n >= 27) + (n >= 50) + (n >= 91) + (n >= 166) + (n >= 305) + (n >= 559);
  return bk + (rel > 0 ? 16 : 0);
}

template <int G>
__device__ __forceinline__ void group_pass(const unsigned short* __restrict__ QKVB, unsigned short* __restrict__ BO, LASB char* lds, int b, int h, int T0, int w, int lane) {
  constexpr int DIL = G == 0 ? 1 : (G == 1 ? 4 : 16); constexpr int L = S / DIL; constexpr int NPASS = G == 2 ? 2 : 1;
  const int r32 = lane & 31, hi = lane >> 5; const int hb = G * 4 + h;
  int rq, mq, mq0;
  if (G == 0)      { rq = 0; mq0 = T0 + 32 * w; mq = mq0 + r32; }
  else if (G == 1) { rq = w & 3; mq0 = T0 / 4 + 32 * (w >> 2); mq = mq0 + r32; }
  else             { rq = 2 * w + (r32 >> 4); mq0 = T0 / 16; mq = mq0 + (r32 & 15); }
  const size_t brow = (size_t)b * S;
  const unsigned short* qp = QKVB + (brow + (size_t)(mq * DIL + rq)) * PITCH + hb * 64 + 8 * hi;
  bf16x8 qf[4];
#pragma unroll
  for (int d0 = 0; d0 < 4; ++d0) qf[d0] = *(const bf16x8*)(qp + 16 * d0);
  float m = -1e30f, lsum = 0.f; f32x16 o0 = {}, o1 = {};
  LASB char* VT = lds + WSCR + w * WSZ; LASB float* AL = (LASB float*)(VT + 32 * VSTR); LASB float* FW = AL + 32;
  const LASB float* bias = (const LASB float*)(lds + BIAS) + G * 132 + 64;
  const LASB char* trb = VT + (4 * hi + ((lane & 15) >> 2)) * VSTR + (16 * ((lane >> 4) & 1) + 4 * (lane & 3)) * 2;
#pragma unroll 1
  for (int pass = 0; pass < NPASS; ++pass) {
    const int rk = G == 2 ? 2 * w + pass : rq;
    const bool resok = G == 2 ? ((r32 >> 4) == pass) : true;
#pragma unroll 1
    for (int tt = 0; tt < 5; ++tt) {
      const int mk0 = mq0 - 64 + 32 * tt;
      int mkc = mk0 + r32; mkc = mkc < 0 ? 0 : (mkc > L - 1 ? L - 1 : mkc);
      const unsigned short* kp = QKVB + (brow + (size_t)(mkc * DIL + rk)) * PITCH + 768 + hb * 64 + 8 * hi;
      bf16x8 kf[4];
#pragma unroll
      for (int d0 = 0; d0 < 4; ++d0) kf[d0] = *(const bf16x8*)(kp + 16 * d0);
      u32x4 vv[4];
#pragma unroll
      for (int i = 0; i < 4; ++i) { const int c = i * 64 + lane, key = c >> 3, part = c & 7; int mkv = mk0 + key; mkv = mkv < 0 ? 0 : (mkv > L - 1 ? L - 1 : mkv);
        vv[i] = *(const u32x4*)(QKVB + (brow + (size_t)(mkv * DIL + rk)) * PITCH + 1536 + hb * 64 + part * 8); }
      f32x16 s = {};
#pragma unroll
      for (int d0 = 0; d0 < 4; ++d0) s = __builtin_amdgcn_mfma_f32_32x32x16_bf16(kf[d0], qf[d0], s, 0, 0, 0);
#pragma unroll
      for (int i = 0; i < 4; ++i) { const int c = i * 64 + lane, key = c >> 3, part = c & 7; *(LASB u32x4*)(VT + key * VSTR + part * 16) = vv[i]; }
      float pmax = -INFINITY;
#pragma unroll
      for (int r = 0; r < 16; ++r) { const int mk = mk0 + crow(r, hi), off = mk - mq; const bool ok = resok && off >= -64 && off <= 64 && mk >= 0 && mk < L;
        const int offc = off < -64 ? -64 : (off > 64 ? 64 : off); const float sv = ok ? s[r] + bias[offc] : -INFINITY; s[r] = sv; pmax = fmaxf(pmax, sv); }
      { auto rr = __builtin_amdgcn_permlane32_swap(__float_as_uint(pmax), __float_as_uint(pmax), false, false); pmax = fmaxf(__uint_as_float(rr[0]), __uint_as_float(rr[1])); }
      const float mn = fmaxf(m, pmax), alpha = __builtin_amdgcn_exp2f(m - mn); m = mn;
      float ps = 0.f;
#pragma unroll
      for (int r = 0; r < 16; ++r) { s[r] = __builtin_amdgcn_exp2f(s[r] - mn); ps += s[r]; }
      lsum = lsum * alpha + ps;
      u32x4 w0 = {cvtpk(s[0], s[1]), cvtpk(s[2], s[3]), cvtpk(s[4], s[5]), cvtpk(s[6], s[7])}, w1 = {cvtpk(s[8], s[9]), cvtpk(s[10], s[11]), cvtpk(s[12], s[13]), cvtpk(s[14], s[15])};
      const bf16x8 pa0 = __builtin_bit_cast(bf16x8, w0), pa1 = __builtin_bit_cast(bf16x8, w1);
      if (hi == 0) AL[r32] = alpha;
      asm volatile("s_waitcnt lgkmcnt(0)" ::: "memory");
#pragma unroll
      for (int r = 0; r < 16; ++r) { const float a = AL[crow(r, hi)]; o0[r] *= a; o1[r] *= a; }
      s16x4 lo[2][2], hh[2][2];
#pragma unroll
      for (int db = 0; db < 2; ++db)
#pragma unroll
        for (int ks = 0; ks < 2; ++ks) { lo[db][ks] = vtr(trb + ks * 16 * VSTR + db * 64); hh[db][ks] = vtr(trb + (ks * 16 + 8) * VSTR + db * 64); }
#define PKV(L_, H_) (bf16x8){L_[0], L_[1], L_[2], L_[3], H_[0], H_[1], H_[2], H_[3]}
      o0 = __builtin_amdgcn_mfma_f32_32x32x16_bf16(pa0, PKV(lo[0][0], hh[0][0]), o0, 0, 0, 0);
      o0 = __builtin_amdgcn_mfma_f32_32x32x16_bf16(pa1, PKV(lo[0][1], hh[0][1]), o0, 0, 0, 0);
      o1 = __builtin_amdgcn_mfma_f32_32x32x16_bf16(pa0, PKV(lo[1][0], hh[1][0]), o1, 0, 0, 0);
      o1 = __builtin_amdgcn_mfma_f32_32x32x16_bf16(pa1, PKV(lo[1][1], hh[1][1]), o1, 0, 0, 0);
#undef PKV
      asm volatile("s_waitcnt lgkmcnt(0)" ::: "memory");
    }
  }
  { auto rr = __builtin_amdgcn_permlane32_swap(__float_as_uint(lsum), __float_as_uint(lsum), false, false); lsum = __uint_as_float(rr[0]) + __uint_as_float(rr[1]); }
  LASB float* MSTp = (LASB float*)(lds + MST); LASB float* LSTp = (LASB float*)(lds + LST); LASB float* OSTp = (LASB float*)(lds + OST);
  const int lrq = mq * DIL + rq - T0;
  float fs = 0.f, fw = 1.f, ltot = lsum, mnew = m;
  if (G > 0) { const float ms = MSTp[lrq], ls = LSTp[lrq]; mnew = fmaxf(ms, m); fs = __builtin_amdgcn_exp2f(ms - mnew); fw = __builtin_amdgcn_exp2f(m - mnew); ltot = ls * fs + lsum * fw; }
  if (G < 2) { if (hi == 0) { MSTp[lrq] = mnew; LSTp[lrq] = ltot; } }
  else { const float inv = 1.0f / ltot; fs *= inv; fw *= inv; }
  if (hi == 0) { AL[r32] = fs; FW[r32] = fw; }
  asm volatile("s_waitcnt lgkmcnt(0)" ::: "memory");
#pragma unroll
  for (int r = 0; r < 16; ++r) { const int qi = crow(r, hi);
    const int lr = G == 0 ? 32 * w + qi : (G == 1 ? 4 * (32 * (w >> 2) + qi) + (w & 3) : 16 * (qi & 15) + 2 * w + (qi >> 4));
    LASB float* orow = OSTp + lr * 64 + r32;
    if (G == 0) { orow[0] = o0[r]; orow[32] = o1[r]; }
    else { const float a = AL[qi], f = FW[qi]; const float v0 = orow[0] * a + o0[r] * f, v1 = orow[32] * a + o1[r] * f;
      if (G == 1) { orow[0] = v0; orow[32] = v1; }
      else { const unsigned pk = cvtpk(v0, v1); unsigned short* op = BO + (brow + (size_t)(T0 + lr)) * 256 + h * 64 + r32; op[0] = (unsigned short)(pk & 0xffffu); op[32] = (unsigned short)(pk >> 16); } } }
}

__device__ __forceinline__ void unit(const unsigned short* QKVB, unsigned short* BO, const float* __restrict__ rel_bias, LASB char* lds, int b, int h, int jb) {
  int tid_ = threadIdx.x; asm volatile("" : "+v"(tid_));
  const int tid = tid_, lane = tid & 63, w = __builtin_amdgcn_readfirstlane(tid >> 6);
  if (tid < 3 * 129) { const int g = tid / 129, o = tid % 129 - 64, dil = g == 0 ? 1 : (g == 1 ? 4 : 16);
    ((LASB float*)(lds + BIAS))[g * 132 + o + 64] = rel_bias[t5_bucket(o * dil) * 12 + g * 4 + h] * 1.4426950408889634f; }
  __syncthreads();
  group_pass<0>(QKVB, BO, lds, b, h, jb * 256, w, lane); __syncthreads();
  group_pass<1>(QKVB, BO, lds, b, h, jb * 256, w, lane); __syncthreads();
  group_pass<2>(QKVB, BO, lds, b, h, jb * 256, w, lane); __syncthreads();
}
#undef LASB
}

#define GAS __attribute__((address_space(1)))
#define LAS __attribute__((address_space(3)))
typedef unsigned short bf16;
typedef unsigned v4u __attribute__((ext_vector_type(4)));
typedef float f32x4 __attribute__((ext_vector_type(4)));
typedef short bf16x8 __attribute__((ext_vector_type(8)));
typedef GAS unsigned gu32;
typedef GAS unsigned long long gu64;
#define RLX_AGENT __ATOMIC_RELAXED, __HIP_MEMORY_SCOPE_AGENT
#define LDS_WAIT() asm volatile("s_waitcnt lgkmcnt(0)" ::: "memory")
#define VM_WAIT() asm volatile("s_waitcnt vmcnt(0)" ::: "memory")
__device__ __forceinline__ unsigned long long rt() { return __builtin_amdgcn_s_memrealtime(); }
__device__ __forceinline__ unsigned f2bf(float f) { unsigned u = __builtin_bit_cast(unsigned, f); return (u + 0x7fffu + ((u >> 16) & 1u)) >> 16; }
__device__ __forceinline__ unsigned pk2(float lo, float hi) { return f2bf(lo) | (f2bf(hi) << 16); }

#define XB_TMO      128
#define XB_XCNT(j)  (256  + 64 * (j))
#define XB_XSUB(j)  (1280 + 64 * (j))
#define XB_XGEN(j)  (2304 + 64 * (j))
#define XB_TOP      3328
#define XB_TOPGEN   3392
#define XCD_BAR_WORDS 3456
#define XB_SPIN_CAP (1u << 18)

__device__ __forceinline__ unsigned xb_ld(unsigned* p)              { return __hip_atomic_load(p, __ATOMIC_RELAXED, __HIP_MEMORY_SCOPE_AGENT); }
__device__ __forceinline__ unsigned xb_add(unsigned* p, unsigned v) { return __hip_atomic_fetch_add(p, v, __ATOMIC_RELAXED, __HIP_MEMORY_SCOPE_AGENT); }
__device__ __forceinline__ unsigned xb_xcc_id() { return (unsigned)__builtin_amdgcn_s_getreg((3 << 11) | 20) & 0xFu; }
#define XB_SPIN(cond, bar) do { unsigned _sp = 0; while (cond) { __builtin_amdgcn_s_sleep(1); \
    if ((++_sp & 255u) == 0u) { if (xb_ld(&(bar)[XB_TMO])) break; if (_sp > XB_SPIN_CAP) { atomicAdd(&(bar)[XB_TMO], 1u); break; } } } } while (0)

struct XcdBarrier {
    unsigned* bar; unsigned x;
    volatile LAS unsigned* st;
};

__device__ __forceinline__ XcdBarrier xcd_barrier_post(unsigned* bar, volatile LAS unsigned* st) {
    XcdBarrier b; b.bar = bar; b.x = xb_xcc_id(); b.st = st;
    if (threadIdx.x == 0) (void)xb_add(&bar[XB_XCNT(b.x)], 1u);
    return b;
}
__device__ __forceinline__ void xcd_barrier_complete(unsigned* bar, unsigned x, unsigned& nloc, unsigned& nx) {
    const unsigned G = gridDim.x * gridDim.y * gridDim.z;
    unsigned sum, cnt, mine, sp = 0u;
    for (;;) {
        sum = 0u; cnt = 0u; mine = 0u;
#pragma unroll
        for (unsigned j = 0; j < 16; ++j) { const unsigned c = xb_ld(&bar[XB_XCNT(j)]); sum += c; cnt += (c > 0u) ? 1u : 0u; mine = (j == x) ? c : mine; }
        if (sum == G) break;
        __builtin_amdgcn_s_sleep(1);
        if ((++sp & 255u) == 0u) { if (xb_ld(&bar[XB_TMO])) break; if (sp > XB_SPIN_CAP) { atomicAdd(&bar[XB_TMO], 1u); break; } }
    }
    nloc = mine > 0u ? mine : 1u; nx = cnt > 0u ? cnt : 1u;
}

__device__ __forceinline__ void xcd_barrier(const XcdBarrier& b) {
    asm volatile("s_waitcnt vmcnt(0)" ::: "memory");
    __syncthreads();
    if (threadIdx.x == 0) {
        unsigned* bar = b.bar;
        __builtin_amdgcn_s_waitcnt(0);
        unsigned nloc = b.st[0], nx = b.st[1];
        if (nloc == 0u) { xcd_barrier_complete(bar, b.x, nloc, nx); b.st[0] = nloc; b.st[1] = nx; }
        const unsigned old = xb_add(&bar[XB_XSUB(b.x)], 1u);
        const unsigned gen = old / nloc;
        if (old + 1u == (gen + 1u) * nloc) {
            __builtin_amdgcn_fence(__ATOMIC_RELEASE, "agent");
            asm volatile("s_waitcnt vmcnt(0)" ::: "memory");
            const unsigned og = xb_add(&bar[XB_TOP], 1u);
            const unsigned tg = og / nx;
            if (og + 1u == (tg + 1u) * nx) xb_add(&bar[XB_TOPGEN], 1u);
            else XB_SPIN(xb_ld(&bar[XB_TOPGEN]) == tg, bar);
            __builtin_amdgcn_fence(__ATOMIC_ACQUIRE, "agent");
            xb_add(&bar[XB_XGEN(b.x)], 1u);
            asm volatile("s_waitcnt vmcnt(0)" ::: "memory");
        } else {
            XB_SPIN(xb_ld(&bar[XB_XGEN(b.x)]) == gen, bar);
            __builtin_amdgcn_fence(__ATOMIC_ACQUIRE, "agent");
            asm volatile("s_waitcnt vmcnt(0)" ::: "memory");
        }
    }
    __syncthreads();
}
__device__ __forceinline__ float wave_sum(float v) {
#pragma unroll
    for (int o = 1; o < 64; o <<= 1) v += __shfl_xor(v, o);
    return v;
}
__device__ __forceinline__ void p0_transpose_item(const float* W, int K, int N, bf16* WT, const float* gk, LAS float* scr, int item, int lane) {
    const int nblk = N / 32, kb = item / nblk, nb = item % nblk, k0 = 64 * kb, n0 = 32 * nb;
#pragma unroll 8
    for (int i = 0; i < 32; ++i) { const int kk = 2 * i + (lane >> 5); float v = W[(size_t)(k0 + kk) * N + n0 + (lane & 31)]; if (gk) v *= gk[k0 + kk]; scr[kk * 33 + (lane & 31)] = v; }
    LDS_WAIT(); asm volatile("" ::: "memory");
    const int c = lane & 7;
#pragma unroll
    for (int j = 0; j < 4; ++j) { const int n = (lane >> 3) + 8 * j; const LAS float* s = scr + (8 * c) * 33 + n;
        v4u o; o.x = pk2(s[0 * 33], s[1 * 33]); o.y = pk2(s[2 * 33], s[3 * 33]); o.z = pk2(s[4 * 33], s[5 * 33]); o.w = pk2(s[6 * 33], s[7 * 33]);
        *(GAS v4u*)(WT + (size_t)(n0 + n) * K + k0 + 8 * c) = o; }
    LDS_WAIT(); asm volatile("" ::: "memory");
}
__device__ __forceinline__ void rms_row_to_bf16(const float* xrow, const float* g, bf16* orow, int lane) {
    const GAS f32x4* xr = (const GAS f32x4*)xrow + lane; const GAS f32x4* gr = (const GAS f32x4*)g + lane;
    f32x4 v[4]; float s = 0.f;
#pragma unroll
    for (int j = 0; j < 4; ++j) { v[j] = xr[64 * j]; s += (v[j].x * v[j].x + v[j].y * v[j].y) + (v[j].z * v[j].z + v[j].w * v[j].w); }
    const float rstd = 1.0f / sqrtf(wave_sum(s) * (1.f / 1024.f) + 1e-6f);
    GAS unsigned long long* o8 = (GAS unsigned long long*)orow + lane;
#pragma unroll
    for (int j = 0; j < 4; ++j) { const f32x4 gg = gr[64 * j]; const f32x4 y = v[j] * rstd * gg;
        o8[64 * j] = (unsigned long long)pk2(y.x, y.y) | ((unsigned long long)pk2(y.z, y.w) << 32); }
}
__device__ __forceinline__ void sincos_acc(double x, float& s, float& c) {
    const double kd = __builtin_rint(x * 0.63661977236758134308); const int k = (int)kd;
    const double r = x - kd * 1.57079632679489661923, r2 = r * r;
    const double sp = r * (1.0 + r2 * (-1.0 / 6 + r2 * (1.0 / 120 + r2 * (-1.0 / 5040 + r2 * (1.0 / 362880 + r2 * (-1.0 / 39916800 + r2 * (1.0 / 6227020800.0)))))));
    const double cp = 1.0 + r2 * (-0.5 + r2 * (1.0 / 24 + r2 * (-1.0 / 720 + r2 * (1.0 / 40320 + r2 * (-1.0 / 3628800 + r2 * (1.0 / 479001600 + r2 * (-1.0 / 87178291200.0)))))));
    const int q = k & 3;
    s = (float)(q == 0 ? sp : (q == 1 ? cp : (q == 2 ? -sp : -cp)));
    c = (float)(q == 0 ? cp : (q == 1 ? -sp : (q == 2 ? -cp : sp)));
}
__device__ __forceinline__ void qk_norm_rope_row(bf16* QA, bf16* KA, const float* qg, const float* kg, const float* tab, int row, int lane) {
    const int t = row & 8191, half = lane >> 5, i = lane & 31, pos = half ? (t & 63) : (t >> 6);
    const float cs = tab[(pos * 32 + i) * 2], sn = tab[(pos * 32 + i) * 2 + 1];
    const int e = 64 * half + i;
    const float gq1 = qg[e], gq2 = qg[e + 32], gk1 = kg[e], gk2 = kg[e + 32];
#pragma unroll
    for (int hh = 0; hh < 10; ++hh) {
        bf16* p = hh < 8 ? QA + (size_t)row * 1024 + hh * 128 + e : KA + (size_t)row * 256 + (hh - 8) * 128 + e;
        const float e1 = __builtin_bit_cast(float, (unsigned)p[0] << 16), e2 = __builtin_bit_cast(float, (unsigned)p[32] << 16);
        const float rstd = 1.0f / sqrtf(wave_sum(e1 * e1 + e2 * e2) * (1.f / 128.f) + 1e-6f);
        const float y1 = e1 * rstd * (hh < 8 ? gq1 : gk1), y2 = e2 * rstd * (hh < 8 ? gq2 : gk2);
        p[0] = (bf16)f2bf(y1 * cs - y2 * sn); p[32] = (bf16)f2bf(y2 * cs + y1 * sn);
    }
}

constexpr int NWAVES = 8;
constexpr int M = 16384, SEQ = 8192, DM = 1024, NIN = 5888, FF = 4096, DP = 256;
constexpr size_t MiB = 1u << 20;
constexpr size_t WS_CTL = 0, CTL_ZERO_BYTES = 1 * MiB;
constexpr size_t WS_TAB = 1 * MiB;
constexpr size_t WS_WIN = 2 * MiB, WS_WOA = WS_WIN + (size_t)NIN * DM * 2, WS_WOB = WS_WOA + 2 * MiB, WS_WO = WS_WOB + MiB / 2, WS_W1 = WS_WO + 2 * MiB,
                 WS_W2 = WS_W1 + 8 * MiB, WS_WPG = WS_W2 + 8 * MiB, WS_WPLE = WS_WPG + 2 * MiB, WS_WEND = WS_WPLE + MiB / 2;
constexpr size_t WS_BO = 37 * MiB;
constexpr size_t WS_QA = 45 * MiB;
constexpr size_t WS_QKVB = 77 * MiB;
constexpr size_t WS_GA = 149 * MiB, WS_GB = 181 * MiB;
constexpr size_t WS_UB = 213 * MiB;
constexpr size_t WS_H = 85 * MiB;
constexpr size_t WS_END = 256 * MiB;
static_assert(WS_WEND <= WS_BO && WS_H + (size_t)M * FF * 2 <= WS_UB && WS_UB + 32 * MiB <= WS_END && WS_QKVB + (size_t)M * 2304 * 2 <= WS_GA, "d_ws map");
constexpr size_t DO_XN = 0, DO_KA = 32 * MiB, DO_VA = 40 * MiB;
constexpr int CW_TMO = 0, CW_CODE = 1, CW_BAR = 4096, CW_SSQ1 = 65536, CW_SSQ2 = CW_SSQ1 + M, CW_SSQ3 = CW_SSQ2 + M;
static_assert((size_t)(CW_SSQ3 + M) * 4 <= CTL_ZERO_BYTES, "ctl");
constexpr int RING_BYTES = 131072, MISC_OFF = RING_BYTES + 320, LDS_BYTES = 147456;

#ifndef PH_MASK
#define PH_MASK 0xFFFF
#endif
#define PH(k) ((PH_MASK >> (k)) & 1)
struct Args { const float* in[18]; float* out; unsigned char* ws; };

__global__ void __launch_bounds__(NWAVES * 64, 2) mega_fwd(Args args) {
    extern __shared__ __attribute__((aligned(16))) unsigned char lds[];
    LAS unsigned char* L = (LAS unsigned char*)lds;
    volatile LAS unsigned* MISC = (volatile LAS unsigned*)(L + MISC_OFF);
    const int tid = threadIdx.x, lane = tid & 63, wave = __builtin_amdgcn_readfirstlane(tid >> 6);
    const int G = gridDim.x, bx = blockIdx.x, vcu = (G % 8 == 0) ? (bx % 8) * (G / 8) + bx / 8 : bx;
    unsigned char* ws = args.ws; unsigned char* dob = (unsigned char*)args.out;
    gu32* ctl = (gu32*)(ws + WS_CTL);
    const float *x = args.in[0], *p = args.in[1], *norm_mix_g = args.in[2], *w_in = args.in[3], *b_gate = args.in[4], *q_norm_g = args.in[5], *k_norm_g = args.in[6], *rel_bias = args.in[7],
                *w_out_a = args.in[8], *w_out_b = args.in[9], *w_out = args.in[10], *norm_mlp_g = args.in[11], *w_ff1 = args.in[12], *w_ff2 = args.in[13], *norm_ple_g = args.in[14],
                *w_ple_gate = args.in[15], *w_ple = args.in[16], *final_norm_g = args.in[17];
    float* out = args.out;
    bf16 *Win_t = (bf16*)(ws + WS_WIN), *Woa_t = (bf16*)(ws + WS_WOA), *Wob_t = (bf16*)(ws + WS_WOB), *Wo_t = (bf16*)(ws + WS_WO), *W1_t = (bf16*)(ws + WS_W1), *W2_t = (bf16*)(ws + WS_W2),
         *Wpg_t = (bf16*)(ws + WS_WPG), *Wple_t = (bf16*)(ws + WS_WPLE);
    bf16 *BO = (bf16*)(ws + WS_BO), *QA = (bf16*)(ws + WS_QA), *QKVB = (bf16*)(ws + WS_QKVB), *GA = (bf16*)(ws + WS_GA), *GB = (bf16*)(ws + WS_GB), *UB = (bf16*)(ws + WS_UB),
         *HB = (bf16*)(ws + WS_H), *PB = (bf16*)(ws + WS_QKVB), *XB = (bf16*)(ws + WS_QA);
    float* PE = (float*)(ws + WS_H); float* tab = (float*)(ws + WS_TAB);
    bf16 *XN = (bf16*)(dob + DO_XN), *KA = (bf16*)(dob + DO_KA), *VA = (bf16*)(dob + DO_VA);
    float *ssq1 = (float*)(ctl + CW_SSQ1), *ssq2 = (float*)(ctl + CW_SSQ2), *ssq3 = (float*)(ctl + CW_SSQ3);

    for (int u = tid; u < (LDS_BYTES - RING_BYTES) / 4; u += NWAVES * 64) ((LAS unsigned*)(L + RING_BYTES))[u] = 0u;
    __syncthreads();
    XcdBarrier bar = xcd_barrier_post((unsigned*)(ctl + CW_BAR), MISC + 8);
    const int gw = vcu * NWAVES + wave, NGW = G * NWAVES;
#define GRID_BAR() xcd_barrier(bar)

    if (PH(0)) {
        LAS float* scr = (LAS float*)(L + wave * 16384);
        constexpr int I_IN = (DM / 64) * (NIN / 32), I_OA = (DM / 64) * (DM / 32), I_OB = (DP / 64) * (DM / 32), I_O = I_OA, I_1 = (DM / 64) * (FF / 32), I_2 = (FF / 64) * (DM / 32), I_PG = I_OA, I_PL = I_OB;
        constexpr int NITEMS = I_IN + I_OA + I_OB + I_O + I_1 + I_2 + I_PG + I_PL;
        for (int it = gw; it < NITEMS; it += NGW) {
            int r = it;
            if (r < I_IN) { p0_transpose_item(w_in, DM, NIN, Win_t, nullptr, scr, r, lane); continue; } r -= I_IN;
            if (r < I_OA) { p0_transpose_item(w_out_a, DM, DM, Woa_t, nullptr, scr, r, lane); continue; } r -= I_OA;
            if (r < I_OB) { p0_transpose_item(w_out_b, DP, DM, Wob_t, nullptr, scr, r, lane); continue; } r -= I_OB;
            if (r < I_O)  { p0_transpose_item(w_out, DM, DM, Wo_t, nullptr, scr, r, lane); continue; } r -= I_O;
            if (r < I_1)  { p0_transpose_item(w_ff1, DM, FF, W1_t, norm_mlp_g, scr, r, lane); continue; } r -= I_1;
            if (r < I_2)  { p0_transpose_item(w_ff2, FF, DM, W2_t, nullptr, scr, r, lane); continue; } r -= I_2;
            if (r < I_PG) { p0_transpose_item(w_ple_gate, DM, DM, Wpg_t, norm_ple_g, scr, r, lane); continue; } r -= I_PG;
            p0_transpose_item(w_ple, DP, DM, Wple_t, nullptr, scr, r, lane);
        }
        for (int m = gw; m < M; m += NGW) rms_row_to_bf16(x + (size_t)m * DM, norm_mix_g, XN + (size_t)m * DM, lane);
        { const int gt = vcu * (NWAVES * 64) + tid;
          if (gt < 128 * 32) { const int pos = gt >> 5, i = gt & 31; double f = 1.0; for (int k = 0; k < i; ++k) f *= 0.7498942093324558;
              const float invf = (float)f; const float ang = (float)pos * invf; float s, c; sincos_acc((double)ang, s, c); tab[gt * 2] = c; tab[gt * 2 + 1] = s; } }
    }
    GRID_BAR();
    if (PH(1)) {
        pg8::Gemm g{XN, Win_t, M, NIN, DM}; pg8::StaticOrder S; S.init(M, NIN, G, bx);
        pg8::EpiInProj E{QA, KA, VA, QKVB, GA, GB, b_gate, 0.125f * 1.4426950408889634f};
        pg8::gemm_phase<pg8::EpiInProj, pg8::StaticOrder, true, true>(L, g, S, E);
    }
    GRID_BAR();
    if (PH(2)) for (int m = gw; m < M; m += NGW) qk_norm_rope_row(QA, KA, q_norm_g, k_norm_g, tab, m, lane);
    GRID_BAR();
    if (PH(3) && G == 256) {
        const int xcd = vcu >> 5, b = xcd >> 2, kvh = (xcd >> 1) & 1;
        if (PH(13)) { const int i = 0;
            const int uidx = (xcd & 1) * 64 + 2 * (vcu & 31) + i, hq = kvh * 4 + (uidx >> 5), qb = uidx & 31;
            const size_t r0 = (size_t)b * SEQ + (size_t)qb * 256;
            typedef const GAS attnA::bf16* gcp_t;
            gcp_t Kh = (gcp_t)(KA + (size_t)b * SEQ * 256 + kvh * 128); gcp_t Vh = (gcp_t)(VA + (size_t)b * SEQ * 256 + kvh * 128);
            asm volatile("" : "+s"(Kh)); asm volatile("" : "+s"(Vh));
            attnA::attn_dense_body((const attnA::bf16*)(QA + r0 * 1024 + hq * 128), (const attnA::bf16*)Kh, (const attnA::bf16*)Vh, (attnA::bf16*)(QA + r0 * 1024 + hq * 128), SEQ, (char*)lds);
            __syncthreads();
        }
        if (PH(13)) { const int i = 1;
            const int uidx = (xcd & 1) * 64 + 2 * (vcu & 31) + i, hq = kvh * 4 + (uidx >> 5), qb = uidx & 31;
            const size_t r0 = (size_t)b * SEQ + (size_t)qb * 256;
            typedef const GAS attnA::bf16* gcp_t;
            gcp_t Kh = (gcp_t)(KA + (size_t)b * SEQ * 256 + kvh * 128); gcp_t Vh = (gcp_t)(VA + (size_t)b * SEQ * 256 + kvh * 128);
            asm volatile("" : "+s"(Kh)); asm volatile("" : "+s"(Vh));
            attnA::attn_dense_body((const attnA::bf16*)(QA + r0 * 1024 + hq * 128), (const attnA::bf16*)Kh, (const attnA::bf16*)Vh, (attnA::bf16*)(QA + r0 * 1024 + hq * 128), SEQ, (char*)lds);
            __syncthreads();
        }
        if (PH(12)) attnB::unit(QKVB, BO, rel_bias, (__attribute__((address_space(3))) char*)L, vcu >> 7, (vcu >> 5) & 3, vcu & 31);
    }
    GRID_BAR();
    if (PH(4)) {
        for (size_t i = (size_t)(vcu * 512 + tid); i < (size_t)M * DP / 8; i += (size_t)G * 512) { const f32x4 a = ((const f32x4*)p)[2 * i], c = ((const f32x4*)p)[2 * i + 1];
            v4u o; o.x = pk2(a.x, a.y); o.y = pk2(a.z, a.w); o.z = pk2(c.x, c.y); o.w = pk2(c.z, c.w); ((v4u*)PB)[i] = o; }
        pg8::Gemm g{QA, Woa_t, M, DM, DM}; pg8::StaticOrder S; S.init(M, DM, G, bx);
        pg8::EpiGateMul E{GA, out};
        pg8::gemm_phase<pg8::EpiGateMul, pg8::StaticOrder, true, true>(L, g, S, E);
    }
    GRID_BAR();
    if (PH(5)) {
        pg8::Gemm g{BO, Wob_t, M, DM, DP}; pg8::StaticOrder S; S.init(M, DM, G, bx);
        pg8::EpiGateAdd E{GB, out, UB};
        pg8::gemm_phase<pg8::EpiGateAdd, pg8::StaticOrder, true, true>(L, g, S, E);
    }
    GRID_BAR();
    if (PH(6)) {
        pg8::Gemm g{UB, Wo_t, M, DM, DM}; pg8::StaticOrder S; S.init(M, DM, G, bx);
        pg8::EpiResid E{x, out, XB, ssq1};
        pg8::gemm_phase<pg8::EpiResid, pg8::StaticOrder, true, true>(L, g, S, E);
    }
    GRID_BAR();
    if (PH(7)) {
        pg8::Gemm g{XB, W1_t, M, FF, DM}; pg8::StaticOrder S; S.init(M, FF, G, bx);
        pg8::EpiFF1 E{HB, ssq1};
        pg8::gemm_phase<pg8::EpiFF1, pg8::StaticOrder, true, true>(L, g, S, E);
    }
    GRID_BAR();
    if (PH(8)) {
        pg8::Gemm g{HB, W2_t, M, DM, FF}; pg8::StaticOrder S; S.init(M, DM, G, bx);
        pg8::EpiResid E{out, out, XB, ssq2};
        pg8::gemm_phase<pg8::EpiResid, pg8::StaticOrder, true, true>(L, g, S, E);
    }
    GRID_BAR();
    if (PH(9)) {
        pg8::Gemm g{PB, Wple_t, M, DM, DP}; pg8::StaticOrder S; S.init(M, DM, G, bx);
        pg8::EpiStoreF32 E{PE};
        pg8::gemm_phase<pg8::EpiStoreF32, pg8::StaticOrder, true, true>(L, g, S, E);
    }
    GRID_BAR();
    if (PH(10)) {
        pg8::Gemm g{XB, Wpg_t, M, DM, DM}; pg8::StaticOrder S; S.init(M, DM, G, bx);
        pg8::EpiPle E{out, PE, ssq2, ssq3};
        pg8::gemm_phase<pg8::EpiPle, pg8::StaticOrder, true, true>(L, g, S, E);
    }
    GRID_BAR();
    if (PH(11)) for (int m = gw; m < M; m += NGW) {
        const float rstd = 1.0f / sqrtf(ssq3[m] * (1.f / 1024.f) + 1e-6f);
        GAS f32x4* xr = (GAS f32x4*)(out + (size_t)m * DM) + lane; const GAS f32x4* gr = (const GAS f32x4*)final_norm_g + lane;
#pragma unroll
        for (int j = 0; j < 4; ++j) xr[64 * j] = xr[64 * j] * rstd * gr[64 * j];
    }
#undef GRID_BAR
}

extern "C" void kernel_launch(void* const* d_in, const int* in_sizes, int n_in, void* d_out, int out_size, void* d_ws, size_t ws_size, hipStream_t stream) {
    static int grid = 0;
    if (grid == 0) {
        if (n_in != 18 || in_sizes[0] != M * DM || out_size != M * DM || ws_size < WS_END) { fprintf(stderr, "kernel_launch: shape mismatch (n_in %d, in0 %d, out %d, ws %zu)\n", n_in, n_in > 0 ? in_sizes[0] : -1, out_size, ws_size); grid = -1; return; }
        int dev = 0, cus = 0;
        if (hipGetDevice(&dev) != hipSuccess || hipDeviceGetAttribute(&cus, hipDeviceAttributeMultiprocessorCount, dev) != hipSuccess) { grid = -1; return; }
        if (hipFuncSetAttribute((const void*)mega_fwd, hipFuncAttributeMaxDynamicSharedMemorySize, LDS_BYTES) != hipSuccess) { fprintf(stderr, "kernel_launch: hipFuncSetAttribute failed\n"); grid = -1; return; }
        int per_cu = 0;
        if (hipOccupancyMaxActiveBlocksPerMultiprocessor(&per_cu, (const void*)mega_fwd, NWAVES * 64, LDS_BYTES) != hipSuccess || per_cu < 1) fprintf(stderr, "kernel_launch: occupancy query says %d\n", per_cu);
        (void)hipGetLastError();
        grid = cus;
        if (grid != 256) fprintf(stderr, "kernel_launch: %d CUs (expected 256)\n", grid);
    }
    if (grid < 0) return;
    if (hipMemsetAsync((char*)d_ws + WS_CTL, 0, CTL_ZERO_BYTES, stream) != hipSuccess) { fprintf(stderr, "kernel_launch: memset failed\n"); return; }
    Args a{};
    for (int i = 0; i < 18; ++i) a.in[i] = (const float*)d_in[i];
    a.out = (float*)d_out; a.ws = (unsigned char*)d_ws;
    hipLaunchKernelGGL(mega_fwd, dim3(grid), dim3(NWAVES * 64), LDS_BYTES, stream, a);
    const hipError_t le = hipPeekAtLastError();
    if (le != hipSuccess) fprintf(stderr, "kernel_launch: launch failed: %s\n", hipGetErrorName(le));
}
```
